# Optimizing an MI355X kernel written in HIP

```python
import jax, jax.numpy as jnp
from jax import lax
import numpy as np

D_MODEL = 1024
BATCH = 2
SEQ = 16384
DEPTH = 1
DEC_BATCH = 16
DEC_SEQ = 16
PAST_LEN = 4096

CHUNK = 64
N_FOX_HEADS = 8
FOX_HEAD_DIM = 64
FOX_WIDTH = N_FOX_HEADS * FOX_HEAD_DIM
GMLP_WIDTH = D_MODEL - FOX_WIDTH
GMLP_GROUPS = 4
GMLP_GROUP_DIM = GMLP_WIDTH // GMLP_GROUPS
GMLP_CHUNK = 128
IN_WIDTH = 3 * FOX_WIDTH + N_FOX_HEADS + 2 * GMLP_WIDTH
N_MEM = 256
N_MEM_HEADS = 4
MEM_HEAD_DIM = D_MODEL // N_MEM_HEADS
D_FF = -(-8 * D_MODEL // (3 * 256)) * 256
Q_BLOCK = 128
ALPHA = (2.0 * DEPTH) ** 0.25
BETA = (8.0 * DEPTH) ** -0.25
FORGET_BIAS_INIT = 3.0
EPS = 1e-5

kernel_name = 'fox_gmlp_memory_streaming_encoder_step'


def layer_norm(x, g, b):
    xf = x.astype(jnp.float32)
    mu = jnp.mean(xf, axis=-1, keepdims=True)
    var = jnp.mean(jnp.square(xf - mu), axis=-1, keepdims=True)
    return ((xf - mu) * lax.rsqrt(var + EPS) * g + b).astype(x.dtype)


def rms_norm(x, g):
    xf = x.astype(jnp.float32)
    return (xf * lax.rsqrt(jnp.mean(jnp.square(xf), axis=-1, keepdims=True) + EPS) * g).astype(x.dtype)


def in_project(x, w_in, b_f):
    z = x @ w_in
    q, k, v, f_logit, zg = jnp.split(
        z, [FOX_WIDTH, 2 * FOX_WIDTH, 3 * FOX_WIDTH, 3 * FOX_WIDTH + N_FOX_HEADS], axis=-1)
    shp = x.shape[:-1] + (N_FOX_HEADS, FOX_HEAD_DIM)
    log_f = jax.nn.log_sigmoid((f_logit + b_f).astype(jnp.float32))
    return q.reshape(shp), k.reshape(shp), v.reshape(shp), log_f, zg


def fox_prompt(q, k, v, log_f):
    B, S, H, Dh = q.shape
    nblk = S // Q_BLOCK
    c = jnp.cumsum(log_f, axis=1)
    c_k = c.transpose(0, 2, 1)
    qb = q.reshape(B, nblk, Q_BLOCK, H, Dh).transpose(1, 0, 2, 3, 4)
    cb = c.reshape(B, nblk, Q_BLOCK, H).transpose(1, 0, 2, 3)
    key_pos = jnp.arange(S)
    scale = Dh ** -0.5

    def block(args):
        i, q_blk, c_blk = args
        s = jnp.einsum('bqhd,bkhd->bhqk', q_blk, k, preferred_element_type=jnp.float32) * scale
        bias = c_blk.transpose(0, 2, 1)[..., :, None] - c_k[:, :, None, :]
        q_pos = i * Q_BLOCK + jnp.arange(Q_BLOCK)
        s = jnp.where(key_pos[None, :] <= q_pos[:, None], s + bias, -jnp.inf)
        p = jax.nn.softmax(s, axis=-1)
        return jnp.einsum('bhqk,bkhd->bqhd', p.astype(v.dtype), v)

    out = lax.map(block, (jnp.arange(nblk), qb, cb))
    return out.transpose(1, 0, 2, 3, 4).reshape(B, S, H * Dh)


def fox_sample(q, k, v, log_f, cache_k, cache_v, cache_lf):
    Bd, T, H, Dh = q.shape
    lf_c = cache_lf.astype(jnp.float32)
    suffix = lax.cumsum(lf_c, axis=1, reverse=True) - lf_c
    c_new = jnp.cumsum(log_f, axis=1).transpose(0, 2, 1)
    bias_past = c_new[..., :, None] + suffix.transpose(0, 2, 1)[..., None, :]
    causal = jnp.tril(jnp.ones((T, T), dtype=bool))
    bias_new = jnp.where(causal, c_new[..., :, None] - c_new[..., None, :], -jnp.inf)
    k_all = jnp.concatenate([cache_k.astype(k.dtype), k], axis=1)
    v_all = jnp.concatenate([cache_v.astype(v.dtype), v], axis=1)
    s = jnp.einsum('bqhd,bkhd->bhqk', q, k_all, preferred_element_type=jnp.float32) * Dh ** -0.5
    s = s + jnp.concatenate([bias_past, bias_new], axis=-1)
    p = jax.nn.softmax(s, axis=-1)
    out = jnp.einsum('bhqk,bkhd->bqhd', p.astype(v_all.dtype), v_all)
    return out.reshape(Bd, T, H * Dh)


def gmlp_mix(zg, ln_g, ln_b, w_s, b_s, n_chunks, chunk_len):
    B = zg.shape[0]
    z = jax.nn.gelu(zg)
    u, v = jnp.split(z, 2, axis=-1)
    v = layer_norm(v, ln_g, ln_b)
    vb = v.reshape(B, n_chunks, chunk_len, GMLP_GROUPS, GMLP_GROUP_DIM)
    pos = jnp.arange(chunk_len)
    mask = (pos[None, :] // CHUNK) <= (pos[:, None] // CHUNK)
    w = jnp.where(mask[None], w_s[:, :chunk_len, :chunk_len], 0)
    mixed = jnp.einsum('gij,bnjgc->bnigc', w, vb) + b_s[:, :chunk_len].T[None, None, :, :, None]
    return u * mixed.reshape(u.shape), v


def merge_groups(att, gm, g_fox_out, g_gmlp_out, w_o):
    h = jnp.concatenate([rms_norm(att, g_fox_out), rms_norm(gm, g_gmlp_out)], axis=-1)
    return h @ w_o


def memory_kv(mem, w_mk, w_mv):
    shp = mem.shape[:-1] + (N_MEM_HEADS, MEM_HEAD_DIM)
    return (mem @ w_mk).reshape(shp), (mem @ w_mv).reshape(shp)


def cross_attend(x, mk, mv, w_mq, w_mo):
    q = (x @ w_mq).reshape(x.shape[:-1] + (N_MEM_HEADS, MEM_HEAD_DIM))
    s = jnp.einsum('bqhd,bkhd->bhqk', q, mk.astype(q.dtype),
                   preferred_element_type=jnp.float32) * MEM_HEAD_DIM ** -0.5
    p = jax.nn.softmax(s, axis=-1)
    o = jnp.einsum('bhqk,bkhd->bqhd', p.astype(q.dtype), mv.astype(q.dtype))
    return o.reshape(x.shape) @ w_mo


def layer_tail(x, mix, mk, mv, ln1_g, ln1_b, w_mq, w_mo, ln2_g, ln2_b,
               w_gate, w_up, w_down, ln3_g, ln3_b):
    x = layer_norm(ALPHA * x + mix, ln1_g, ln1_b)
    x = layer_norm(ALPHA * x + cross_attend(x, mk, mv, w_mq, w_mo), ln2_g, ln2_b)
    ffn = (jax.nn.silu(x @ w_gate) * (x @ w_up)) @ w_down
    return layer_norm(ALPHA * x + ffn, ln3_g, ln3_b)


def setup_inputs(seed: int = 0) -> dict:
    key = jax.random.key(seed)
    ks = jax.random.split(key, 32)
    L = DEPTH

    def nrm(k, shape, scale=1.0):
        return jax.random.normal(k, shape, jnp.float32) * scale

    def gain(k, n):
        return 1.0 + 0.01 * jax.random.normal(k, (L, n), jnp.float32)

    def bias(k, n):
        return 0.01 * jax.random.normal(k, (L, n), jnp.float32)

    return {
        'x_prompt': nrm(ks[0], (BATCH, SEQ, D_MODEL)),
        'x_sample': nrm(ks[1], (DEC_BATCH, DEC_SEQ, D_MODEL)),
        'cache_fox_k': nrm(ks[2], (L, DEC_BATCH, PAST_LEN, N_FOX_HEADS, FOX_HEAD_DIM)),
        'cache_fox_v': nrm(ks[3], (L, DEC_BATCH, PAST_LEN, N_FOX_HEADS, FOX_HEAD_DIM)),
        'cache_fox_logf': jax.nn.log_sigmoid(FORGET_BIAS_INIT + nrm(ks[4], (L, DEC_BATCH, PAST_LEN, N_FOX_HEADS))),
        'cache_mem_k': nrm(ks[5], (L, DEC_BATCH, N_MEM, N_MEM_HEADS, MEM_HEAD_DIM)),
        'cache_mem_v': nrm(ks[6], (L, DEC_BATCH, N_MEM, N_MEM_HEADS, MEM_HEAD_DIM)),
        'mem_prompt': nrm(ks[7], (BATCH, N_MEM, D_MODEL)),
        'w_in': nrm(ks[8], (L, D_MODEL, IN_WIDTH), D_MODEL ** -0.5),
        'b_f': FORGET_BIAS_INIT + nrm(ks[9], (L, N_FOX_HEADS), 0.1),
        'g_fox_out': gain(ks[10], FOX_WIDTH),
        'g_gmlp_out': gain(ks[11], GMLP_WIDTH),
        'sgu_ln_g': gain(ks[12], GMLP_WIDTH),
        'sgu_ln_b': bias(ks[13], GMLP_WIDTH),
        'w_s': nrm(ks[14], (L, GMLP_GROUPS, GMLP_CHUNK, GMLP_CHUNK), 0.5 * GMLP_CHUNK ** -0.5),
        'b_s': 1.0 + nrm(ks[15], (L, GMLP_GROUPS, GMLP_CHUNK), 0.1),
        'w_o': nrm(ks[16], (L, D_MODEL, D_MODEL), BETA * D_MODEL ** -0.5),
        'ln1_g': gain(ks[17], D_MODEL),
        'ln1_b': bias(ks[18], D_MODEL),
        'w_mq': nrm(ks[19], (L, D_MODEL, D_MODEL), D_MODEL ** -0.5),
        'w_mk': nrm(ks[20], (L, D_MODEL, D_MODEL), D_MODEL ** -0.5),
        'w_mv': nrm(ks[21], (L, D_MODEL, D_MODEL), D_MODEL ** -0.5),
        'w_mo': nrm(ks[22], (L, D_MODEL, D_MODEL), BETA * D_MODEL ** -0.5),
        'ln2_g': gain(ks[23], D_MODEL),
        'ln2_b': bias(ks[24], D_MODEL),
        'w_gate': nrm(ks[25], (L, D_MODEL, D_FF), D_MODEL ** -0.5),
        'w_up': nrm(ks[26], (L, D_MODEL, D_FF), D_MODEL ** -0.5),
        'w_down': nrm(ks[27], (L, D_FF, D_MODEL), BETA * D_FF ** -0.5),
        'ln3_g': gain(ks[28], D_MODEL),
        'ln3_b': bias(ks[29], D_MODEL),
    }


def reference(x_prompt, x_sample, cache_fox_k, cache_fox_v, cache_fox_logf, cache_mem_k, cache_mem_v,
              mem_prompt, w_in, b_f, g_fox_out, g_gmlp_out, sgu_ln_g, sgu_ln_b, w_s, b_s, w_o,
              ln1_g, ln1_b, w_mq, w_mk, w_mv, w_mo, ln2_g, ln2_b, w_gate, w_up, w_down, ln3_g, ln3_b):
    yp, ys = x_prompt, x_sample
    T = x_sample.shape[1]
    kp, vp, lfp, mkp, mvp, ksm, vsm, lfs, gvs = [], [], [], [], [], [], [], [], []
    for l in range(DEPTH):
        tail = dict(ln1_g=ln1_g[l], ln1_b=ln1_b[l], w_mq=w_mq[l], w_mo=w_mo[l], ln2_g=ln2_g[l],
                    ln2_b=ln2_b[l], w_gate=w_gate[l], w_up=w_up[l], w_down=w_down[l],
                    ln3_g=ln3_g[l], ln3_b=ln3_b[l])
        q, k, v, lf, zg = in_project(yp, w_in[l], b_f[l])
        att = fox_prompt(q, k, v, lf)
        gm, _ = gmlp_mix(zg, sgu_ln_g[l], sgu_ln_b[l], w_s[l], b_s[l], yp.shape[1] // GMLP_CHUNK, GMLP_CHUNK)
        mk, mv = memory_kv(mem_prompt, w_mk[l], w_mv[l])
        mix = merge_groups(att, gm, g_fox_out[l], g_gmlp_out[l], w_o[l])
        yp = layer_tail(yp, mix, mk, mv, **tail)
        kp.append(k); vp.append(v); lfp.append(lf); mkp.append(mk); mvp.append(mv)
        q, k, v, lf, zg = in_project(ys, w_in[l], b_f[l])
        att = fox_sample(q, k, v, lf, cache_fox_k[l], cache_fox_v[l], cache_fox_logf[l])
        gm, gv = gmlp_mix(zg, sgu_ln_g[l], sgu_ln_b[l], w_s[l], b_s[l], 1, T)
        mix = merge_groups(att, gm, g_fox_out[l], g_gmlp_out[l], w_o[l])
        ys = layer_tail(ys, mix, cache_mem_k[l], cache_mem_v[l], **tail)
        ksm.append(k); vsm.append(v); lfs.append(lf); gvs.append(gv)
    return (yp, ys, jnp.stack(kp), jnp.stack(vp), jnp.stack(lfp), jnp.stack(mkp), jnp.stack(mvp),
            jnp.stack(ksm), jnp.stack(vsm), jnp.stack(lfs), jnp.stack(gvs))
```

```cpp
#include <hip/hip_runtime.h>
#include <cstdint>
#include <cstdio>
#include <cmath>

namespace simple {
constexpr int DM = 1024, SEQ = 16384, NB = 2, MP = NB * SEQ, MS = 256, R = MP + MS, INW = 2568, DFF = 2816, PAST = 4096;
constexpr long O_Y = 0, O_YS = 33554432, O_FK = 33816576, O_FV = O_FK + 16777216, O_LF = O_FV + 16777216, O_MK = O_LF + 262144, O_MV = O_MK + 524288,
               O_FKS = O_MV + 524288, O_FVS = O_FKS + 131072, O_LFS = O_FVS + 131072, O_GVS = O_LFS + 2048, O_END = O_GVS + 131072;
constexpr float ALPHA = 1.189207115002721f, EPS = 1e-5f;

struct GemmArgs { const float* A; const float* B; float* C; int lda, ldb, ldc, M, N, K, nInner; long sAo, sAi, sBo, sBi, sCo, sCi; };

template <bool TB> __global__ __launch_bounds__(256) void sgemm_k(GemmArgs g) {
    const int z = blockIdx.z, zo = z / g.nInner, zi = z % g.nInner;
    const float* A = g.A + zo * g.sAo + zi * g.sAi; const float* B = g.B + zo * g.sBo + zi * g.sBi; float* C = g.C + zo * g.sCo + zi * g.sCi;
    __shared__ float As[8][132]; __shared__ float Bs[8][132];
    const int tid = threadIdx.x, tx = tid & 15, ty = tid >> 4, m0 = blockIdx.y * 128, n0 = blockIdx.x * 128;
    const int M = g.M, N = g.N, K = g.K;
    float acc[8][8];
#pragma unroll
    for (int i = 0; i < 8; ++i)
#pragma unroll
        for (int j = 0; j < 8; ++j) acc[i][j] = 0.f;
    for (int k0 = 0; k0 < K; k0 += 8) {
        { const int r = m0 + (tid >> 1), kk = (tid & 1) * 4; float4 v = make_float4(0.f, 0.f, 0.f, 0.f);
          if (r < M) v = *(const float4*)(A + (long)r * g.lda + k0 + kk);
          As[kk][tid >> 1] = v.x; As[kk + 1][tid >> 1] = v.y; As[kk + 2][tid >> 1] = v.z; As[kk + 3][tid >> 1] = v.w; }
        if (!TB) { const int kk = tid >> 5, n = (tid & 31) * 4, c = n0 + n; float4 v = make_float4(0.f, 0.f, 0.f, 0.f);
          const float* bp = B + (long)(k0 + kk) * g.ldb + c;
          if (c + 3 < N) v = *(const float4*)bp; else { if (c < N) v.x = bp[0]; if (c + 1 < N) v.y = bp[1]; if (c + 2 < N) v.z = bp[2]; }
          Bs[kk][n] = v.x; Bs[kk][n + 1] = v.y; Bs[kk][n + 2] = v.z; Bs[kk][n + 3] = v.w; }
        else { const int n = tid >> 1, kk = (tid & 1) * 4, c = n0 + n; float4 v = make_float4(0.f, 0.f, 0.f, 0.f);
          if (c < N) v = *(const float4*)(B + (long)c * g.ldb + k0 + kk);
          Bs[kk][n] = v.x; Bs[kk + 1][n] = v.y; Bs[kk + 2][n] = v.z; Bs[kk + 3][n] = v.w; }
        __syncthreads();
#pragma unroll
        for (int kk = 0; kk < 8; ++kk) {
            float a[8], b[8];
#pragma unroll
            for (int i = 0; i < 8; ++i) a[i] = As[kk][ty * 8 + i];
#pragma unroll
            for (int j = 0; j < 8; ++j) b[j] = Bs[kk][tx * 8 + j];
#pragma unroll
            for (int i = 0; i < 8; ++i)
#pragma unroll
                for (int j = 0; j < 8; ++j) acc[i][j] = fmaf(a[i], b[j], acc[i][j]);
        }
        __syncthreads();
    }
#pragma unroll
    for (int i = 0; i < 8; ++i) { const int r = m0 + ty * 8 + i; if (r >= M) continue;
#pragma unroll
        for (int j = 0; j < 8; ++j) { const int c = n0 + tx * 8 + j; if (c < N) C[(long)r * g.ldc + c] = acc[i][j]; } }
}

__device__ __forceinline__ float wave_sum(float v) {
#pragma unroll
    for (int o = 1; o < 64; o <<= 1) v += __shfl_xor(v, o);
    return v;
}
__device__ __forceinline__ float wave_max(float v) {
#pragma unroll
    for (int o = 1; o < 64; o <<= 1) v = fmaxf(v, __shfl_xor(v, o));
    return v;
}

__global__ __launch_bounds__(256) void fox_prompt_simple(const float* Q, const float* Kp, const float* Vp, const float* Cc, float* O, int ldo) {
    const int qb = (int)gridDim.x - 1 - (int)blockIdx.x, h = blockIdx.y, b = blockIdx.z, tid = threadIdx.x;
    __shared__ float Ks[64][64]; __shared__ float Vs[64][64]; __shared__ float cks[64];
    const int t = qb * 256 + tid; const long row = (long)b * SEQ + t;
    float q[64], o[64];
#pragma unroll
    for (int d = 0; d < 64; d += 4) { const float4 v = *(const float4*)(Q + row * 512 + h * 64 + d); q[d] = v.x * 0.125f; q[d + 1] = v.y * 0.125f; q[d + 2] = v.z * 0.125f; q[d + 3] = v.w * 0.125f; }
#pragma unroll
    for (int d = 0; d < 64; ++d) o[d] = 0.f;
    const float cq = Cc[row * 8 + h]; float m = -INFINITY, l = 0.f;
    const int ntiles = (qb * 256 + 256) / 64;
    for (int j = 0; j < ntiles; ++j) {
        __syncthreads();
#pragma unroll
        for (int i = 0; i < 4; ++i) { const int idx = tid + i * 256, key = idx >> 4, c4 = (idx & 15) * 4; const long kr = ((long)b * SEQ + j * 64 + key) * 512 + h * 64 + c4;
            *(float4*)&Ks[key][c4] = *(const float4*)(Kp + kr); *(float4*)&Vs[key][c4] = *(const float4*)(Vp + kr); }
        if (tid < 64) cks[tid] = Cc[((long)b * SEQ + j * 64 + tid) * 8 + h];
        __syncthreads();
        for (int s = 0; s < 64; ++s) {
            const int key = j * 64 + s;
            if (key <= t) {
                float dot = 0.f;
#pragma unroll
                for (int d = 0; d < 64; ++d) dot = fmaf(q[d], Ks[s][d], dot);
                const float lg = dot + (cq - cks[s]);
                const float mn = fmaxf(m, lg), corr = __expf(m - mn), p = __expf(lg - mn);
                l = l * corr + p; m = mn;
#pragma unroll
                for (int d = 0; d < 64; ++d) o[d] = fmaf(p, Vs[s][d], o[d] * corr);
            }
        }
    }
    const float inv = 1.f / l;
#pragma unroll
    for (int d = 0; d < 64; d += 4) *(float4*)(O + row * ldo + h * 64 + d) = make_float4(o[d] * inv, o[d + 1] * inv, o[d + 2] * inv, o[d + 3] * inv);
}

__global__ __launch_bounds__(256) void fox_sample_simple(const float* Qs, const float* kc, const float* vc, const float* knew, const float* vnew, const float* Cn, const float* SUF, float* O, int ldo) {
    const int t = blockIdx.x, h = blockIdx.y, b = blockIdx.z, tid = threadIdx.x, lane = tid & 63, wid = tid >> 6;
    const int row = b * 16 + t;
    __shared__ float red[4]; __shared__ float ored[4][64];
    float q[64];
#pragma unroll
    for (int d = 0; d < 64; d += 4) { const float4 v = *(const float4*)(Qs + (long)row * 512 + h * 64 + d); q[d] = v.x * 0.125f; q[d + 1] = v.y * 0.125f; q[d + 2] = v.z * 0.125f; q[d + 3] = v.w * 0.125f; }
    const float cn = Cn[row * 8 + h];
    float sc[17]; float mx = -INFINITY;
#pragma unroll
    for (int i = 0; i < 17; ++i) {
        const int s = tid + i * 256; float v = -INFINITY;
        const float* kr = nullptr; float bias = 0.f;
        if (s < PAST) { kr = kc + (((long)b * PAST + s) * 8 + h) * 64; bias = cn + SUF[((long)b * PAST + s) * 8 + h]; }
        else if (s < PAST + 16 && (s - PAST) <= t) { const int s2 = s - PAST; kr = knew + ((long)(b * 16 + s2) * 8 + h) * 64; bias = cn - Cn[(b * 16 + s2) * 8 + h]; }
        if (kr) { float dot = 0.f;
#pragma unroll
            for (int d = 0; d < 64; d += 4) { const float4 kv = *(const float4*)(kr + d); dot = fmaf(q[d], kv.x, dot); dot = fmaf(q[d + 1], kv.y, dot); dot = fmaf(q[d + 2], kv.z, dot); dot = fmaf(q[d + 3], kv.w, dot); }
            v = dot + bias; }
        sc[i] = v; mx = fmaxf(mx, v);
    }
    mx = wave_max(mx); if (lane == 0) red[wid] = mx; __syncthreads();
    mx = fmaxf(fmaxf(red[0], red[1]), fmaxf(red[2], red[3])); __syncthreads();
    float sum = 0.f; float o[64];
#pragma unroll
    for (int d = 0; d < 64; ++d) o[d] = 0.f;
#pragma unroll
    for (int i = 0; i < 17; ++i) {
        const int s = tid + i * 256; const float p = __expf(sc[i] - mx); sum += p;
        const float* vr = nullptr;
        if (s < PAST) vr = vc + (((long)b * PAST + s) * 8 + h) * 64; else if (s < PAST + 16 && (s - PAST) <= t) vr = vnew + ((long)(b * 16 + (s - PAST)) * 8 + h) * 64;
        if (vr) {
#pragma unroll
            for (int d = 0; d < 64; d += 4) { const float4 vv = *(const float4*)(vr + d); o[d] = fmaf(p, vv.x, o[d]); o[d + 1] = fmaf(p, vv.y, o[d + 1]); o[d + 2] = fmaf(p, vv.z, o[d + 2]); o[d + 3] = fmaf(p, vv.w, o[d + 3]); } }
    }
    sum = wave_sum(sum); if (lane == 0) red[wid] = sum;
#pragma unroll
    for (int d = 0; d < 64; ++d) { const float v = wave_sum(o[d]); if (lane == 0) ored[wid][d] = v; }
    __syncthreads();
    if (tid < 64) { const float tot = red[0] + red[1] + red[2] + red[3]; O[(long)row * ldo + h * 64 + tid] = (ored[0][tid] + ored[1][tid] + ored[2][tid] + ored[3][tid]) / tot; }
}

__global__ __launch_bounds__(64) void scan_k(const float* in, float* out, int len, long strideB, int mode) {
    const int seq = blockIdx.x, b = seq >> 3, h = seq & 7, lane = threadIdx.x;
    const float* ip = in + (long)b * strideB + h; float* op = out + (long)b * strideB + h;
    const int per = (len + 63) / 64, i0 = lane * per, i1 = min(len, i0 + per);
    float s = 0.f;
    for (int i = i0; i < i1; ++i) { const int p = mode ? len - 1 - i : i; s += ip[(long)p * 8]; }
    float incl = s;
#pragma unroll
    for (int o = 1; o < 64; o <<= 1) { const float v = __shfl_up(incl, o); if (lane >= o) incl += v; }
    float run = incl - s;
    for (int i = i0; i < i1; ++i) { const int p = mode ? len - 1 - i : i; const float x = ip[(long)p * 8]; if (mode) { op[(long)p * 8] = run; run += x; } else { run += x; op[(long)p * 8] = run; } }
}

__global__ __launch_bounds__(256) void ln_rows(const float* a, int lda, float alpha, const float* b2, int ldb, const float* g, const float* beta, float* out, int ldo, int W, int nrows, float* out2, int ldo2) {
    const int row = blockIdx.x * 4 + (threadIdx.x >> 6), lane = threadIdx.x & 63; if (row >= nrows) return;
    float v[16]; float s = 0.f; const int n = W / 64;
#pragma unroll
    for (int i = 0; i < 16; ++i) if (i < n) { const int c = lane + 64 * i; float x = alpha * a[(long)row * lda + c]; if (b2) x += b2[(long)row * ldb + c]; v[i] = x; s += x; }
    const float mu = wave_sum(s) / (float)W; float q = 0.f;
#pragma unroll
    for (int i = 0; i < 16; ++i) if (i < n) { const float d = v[i] - mu; q += d * d; }
    const float rstd = 1.0f / sqrtf(wave_sum(q) / (float)W + EPS);
#pragma unroll
    for (int i = 0; i < 16; ++i) if (i < n) { const int c = lane + 64 * i; const float y = (v[i] - mu) * rstd * g[c] + beta[c]; out[(long)row * ldo + c] = y; if (out2) out2[(long)row * ldo2 + c] = y; }
}
__global__ __launch_bounds__(256) void rms_rows(float* x, int ld, const float* g, int W, int nrows) {
    const int row = blockIdx.x * 4 + (threadIdx.x >> 6), lane = threadIdx.x & 63; if (row >= nrows) return;
    float v[16]; float q = 0.f; const int n = W / 64;
#pragma unroll
    for (int i = 0; i < 16; ++i) if (i < n) { v[i] = x[(long)row * ld + lane + 64 * i]; q += v[i] * v[i]; }
    const float r = 1.0f / sqrtf(wave_sum(q) / (float)W + EPS);
#pragma unroll
    for (int i = 0; i < 16; ++i) if (i < n) { const int c = lane + 64 * i; x[(long)row * ld + c] = v[i] * r * g[c]; }
}
__global__ __launch_bounds__(256) void softmax_rows(float* x, float scale, long nrows) {
    const long row = (long)blockIdx.x * 4 + (threadIdx.x >> 6); const int lane = threadIdx.x & 63; if (row >= nrows) return;
    float v[4]; float mx = -INFINITY;
#pragma unroll
    for (int i = 0; i < 4; ++i) { v[i] = x[row * 256 + lane + 64 * i] * scale; mx = fmaxf(mx, v[i]); }
    mx = wave_max(mx); float s = 0.f;
#pragma unroll
    for (int i = 0; i < 4; ++i) { v[i] = __expf(v[i] - mx); s += v[i]; }
    s = 1.f / wave_sum(s);
#pragma unroll
    for (int i = 0; i < 4; ++i) x[row * 256 + lane + 64 * i] = v[i] * s;
}
__device__ __forceinline__ float gelu_tanh(float x) { const float u = 0.7978845608028654f * (x + 0.044715f * x * x * x); return 0.5f * x * (1.f + tanhf(u)); }
__global__ void gelu_k(float* x, long n) { const long i = (long)blockIdx.x * blockDim.x + threadIdx.x; if (i < n) x[i] = gelu_tanh(x[i]); }
__global__ void logf_k(const float* F, const float* bf, float* outp, float* outs) {
    const long i = (long)blockIdx.x * blockDim.x + threadIdx.x; if (i >= (long)R * 8) return;
    const float z = F[i] + bf[i & 7]; const float ls = fminf(z, 0.f) - log1pf(__expf(-fabsf(z)));
    if (i < (long)MP * 8) outp[i] = ls; else outs[i - (long)MP * 8] = ls;
}
__global__ void swiglu_k(float* G, const float* U, long n) { const long i = (long)blockIdx.x * blockDim.x + threadIdx.x; if (i < n) { const float g = G[i]; G[i] = g / (1.f + __expf(-g)) * U[i]; } }
__global__ void maskw_k(const float* ws, float* WM) { const int i = blockIdx.x * blockDim.x + threadIdx.x; if (i >= 4 * 128 * 128) return; const int r = (i >> 7) & 127, c = i & 127; WM[i] = ((c >> 6) <= (r >> 6)) ? ws[i] : 0.f; }
__global__ void gmcomb_k(const float* ZG, const float* MIX, const float* bs, float* H) {
    const long i = (long)blockIdx.x * blockDim.x + threadIdx.x; if (i >= (long)R * 512) return;
    const long r = i >> 9; const int c = (int)(i & 511), g = c >> 7; const int pos = r < MP ? (int)(r & 127) : (int)((r - MP) & 15);
    H[r * 1024 + 512 + c] = ZG[r * 1024 + c] * (MIX[r * 512 + c] + bs[g * 128 + pos]);
}

static void gemm(hipStream_t st, bool tb, const float* A, int lda, const float* B, int ldb, float* C, int ldc, int M, int N, int K,
                 int nz = 1, int nInner = 1, long sAo = 0, long sAi = 0, long sBo = 0, long sBi = 0, long sCo = 0, long sCi = 0) {
    GemmArgs g{A, B, C, lda, ldb, ldc, M, N, K, nInner, sAo, sAi, sBo, sBi, sCo, sCi};
    dim3 grid((N + 127) / 128, (M + 127) / 128, nz);
    if (tb) hipLaunchKernelGGL(sgemm_k<true>, grid, dim3(256), 0, st, g); else hipLaunchKernelGGL(sgemm_k<false>, grid, dim3(256), 0, st, g);
}
}

extern "C" void kernel_launch(void* const* d_in, const int* in_sizes, int n_in, void* d_out, int out_size, void* d_ws, size_t ws_size, hipStream_t stream) {
    using namespace simple;
    if (n_in != 30 || out_size != (int)O_END) { fprintf(stderr, "kernel_launch: unexpected n_in %d / out_size %d\n", n_in, out_size); }
    const float* xp = (const float*)d_in[0]; const float* xs = (const float*)d_in[1];
    const float* cfk = (const float*)d_in[2]; const float* cfv = (const float*)d_in[3]; const float* cflf = (const float*)d_in[4];
    const float* cmk = (const float*)d_in[5]; const float* cmv = (const float*)d_in[6]; const float* memp = (const float*)d_in[7];
    const float* w_in = (const float*)d_in[8]; const float* b_f = (const float*)d_in[9]; const float* g_fox = (const float*)d_in[10]; const float* g_gm = (const float*)d_in[11];
    const float* sgu_g = (const float*)d_in[12]; const float* sgu_b = (const float*)d_in[13]; const float* w_s = (const float*)d_in[14]; const float* b_s = (const float*)d_in[15];
    const float* w_o = (const float*)d_in[16]; const float* ln1g = (const float*)d_in[17]; const float* ln1b = (const float*)d_in[18];
    const float* w_mq = (const float*)d_in[19]; const float* w_mk = (const float*)d_in[20]; const float* w_mv = (const float*)d_in[21]; const float* w_mo = (const float*)d_in[22];
    const float* ln2g = (const float*)d_in[23]; const float* ln2b = (const float*)d_in[24];
    const float* w_gate = (const float*)d_in[25]; const float* w_up = (const float*)d_in[26]; const float* w_down = (const float*)d_in[27];
    const float* ln3g = (const float*)d_in[28]; const float* ln3b = (const float*)d_in[29];
    float* out = (float*)d_out; float* ws = (float*)d_ws;
    float* Q = ws; float* ZG = Q + (long)R * 512; float* H = ZG + (long)R * 1024; float* X1 = H + (long)R * 1024;
    float* F = X1 + (long)R * 1024; float* CC = F + (long)R * 8; float* SUF = CC + (long)R * 8; float* WM = SUF + 16L * PAST * 8;
    float* MIX = Q;
    hipStream_t st = stream;
    for (int seg = 0; seg < 2; ++seg) {
        const float* x = seg ? xs : xp; const int M = seg ? MS : MP; const long r0 = seg ? MP : 0;
        gemm(st, false, x, 1024, w_in, INW, Q + r0 * 512, 512, M, 512, 1024);
        gemm(st, false, x, 1024, w_in + 512, INW, out + (seg ? O_FKS : O_FK), 512, M, 512, 1024);
        gemm(st, false, x, 1024, w_in + 1024, INW, out + (seg ? O_FVS : O_FV), 512, M, 512, 1024);
        gemm(st, false, x, 1024, w_in + 1536, INW, F + r0 * 8, 8, M, 8, 1024);
        gemm(st, false, x, 1024, w_in + 1544, INW, ZG + r0 * 1024, 1024, M, 1024, 1024);
    }
    hipLaunchKernelGGL(logf_k, dim3((R * 8 + 255) / 256), dim3(256), 0, st, F, b_f, out + O_LF, out + O_LFS);
    hipLaunchKernelGGL(scan_k, dim3(16), dim3(64), 0, st, out + O_LF, CC, SEQ, (long)SEQ * 8, 0);
    hipLaunchKernelGGL(scan_k, dim3(128), dim3(64), 0, st, out + O_LFS, CC + (long)MP * 8, 16, 16L * 8, 0);
    hipLaunchKernelGGL(scan_k, dim3(128), dim3(64), 0, st, cflf, SUF, PAST, (long)PAST * 8, 1);
    hipLaunchKernelGGL(gelu_k, dim3((unsigned)(((long)R * 1024 + 255) / 256)), dim3(256), 0, st, ZG, (long)R * 1024);
    hipLaunchKernelGGL(ln_rows, dim3(MP / 4), dim3(256), 0, st, ZG + 512, 1024, 1.0f, (const float*)nullptr, 0, sgu_g, sgu_b, ZG + 512, 1024, 512, MP, (float*)nullptr, 0);
    hipLaunchKernelGGL(ln_rows, dim3(MS / 4), dim3(256), 0, st, ZG + (long)MP * 1024 + 512, 1024, 1.0f, (const float*)nullptr, 0, sgu_g, sgu_b, ZG + (long)MP * 1024 + 512, 1024, 512, MS, out + O_GVS, 512);
    hipLaunchKernelGGL(fox_prompt_simple, dim3(SEQ / 256, 8, NB), dim3(256), 0, st, Q, out + O_FK, out + O_FV, CC, H, 1024);
    hipLaunchKernelGGL(fox_sample_simple, dim3(16, 8, 16), dim3(256), 0, st, Q + (long)MP * 512, cfk, cfv, out + O_FKS, out + O_FVS, CC + (long)MP * 8, SUF, H + (long)MP * 1024, 1024);
    hipLaunchKernelGGL(maskw_k, dim3(256), dim3(256), 0, st, w_s, WM);
    gemm(st, false, WM, 128, ZG + 512, 1024, MIX, 512, 128, 128, 128, 256 * 4, 4, 0, 16384, 128L * 1024, 128, 128L * 512, 128);
    gemm(st, false, WM, 128, ZG + (long)MP * 1024 + 512, 1024, MIX + (long)MP * 512, 512, 16, 128, 16, 16 * 4, 4, 0, 16384, 16L * 1024, 128, 16L * 512, 128);
    hipLaunchKernelGGL(gmcomb_k, dim3((unsigned)(((long)R * 512 + 255) / 256)), dim3(256), 0, st, ZG, MIX, b_s, H);
    hipLaunchKernelGGL(rms_rows, dim3(R / 4), dim3(256), 0, st, H, 1024, g_fox, 512, R);
    hipLaunchKernelGGL(rms_rows, dim3(R / 4), dim3(256), 0, st, H + 512, 1024, g_gm, 512, R);
    gemm(st, false, H, 1024, w_o, 1024, X1, 1024, R, 1024, 1024);
    hipLaunchKernelGGL(ln_rows, dim3(MP / 4), dim3(256), 0, st, xp, 1024, ALPHA, X1, 1024, ln1g, ln1b, X1, 1024, 1024, MP, (float*)nullptr, 0);
    hipLaunchKernelGGL(ln_rows, dim3(MS / 4), dim3(256), 0, st, xs, 1024, ALPHA, X1 + (long)MP * 1024, 1024, ln1g, ln1b, X1 + (long)MP * 1024, 1024, 1024, MS, (float*)nullptr, 0);
    gemm(st, false, X1, 1024, w_mq, 1024, ZG, 1024, R, 1024, 1024);
    gemm(st, false, memp, 1024, w_mk, 1024, out + O_MK, 1024, 512, 1024, 1024);
    gemm(st, false, memp, 1024, w_mv, 1024, out + O_MV, 1024, 512, 1024, 1024);
    gemm(st, true, ZG, 1024, out + O_MK, 1024, H, 1024, SEQ, 256, 256, 8, 4, (long)SEQ * 1024, 256, 256L * 1024, 256, (long)SEQ * 1024, 256);
    gemm(st, true, ZG + (long)MP * 1024, 1024, cmk, 1024, H + (long)MP * 1024, 1024, 16, 256, 256, 64, 4, 16L * 1024, 256, 256L * 1024, 256, 16L * 1024, 256);
    hipLaunchKernelGGL(softmax_rows, dim3(R), dim3(256), 0, st, H, 0.0625f, (long)R * 4);
    gemm(st, false, H, 1024, out + O_MV, 1024, ZG, 1024, SEQ, 256, 256, 8, 4, (long)SEQ * 1024, 256, 256L * 1024, 256, (long)SEQ * 1024, 256);
    gemm(st, false, H + (long)MP * 1024, 1024, cmv, 1024, ZG + (long)MP * 1024, 1024, 16, 256, 256, 64, 4, 16L * 1024, 256, 256L * 1024, 256, 16L * 1024, 256);
    gemm(st, false, ZG, 1024, w_mo, 1024, H, 1024, R, 1024, 1024);
    hipLaunchKernelGGL(ln_rows, dim3(R / 4), dim3(256), 0, st, X1, 1024, ALPHA, H, 1024, ln2g, ln2b, X1, 1024, 1024, R, (float*)nullptr, 0);
    float* G = ws; float* UP = ws + 11008L * DFF;
    for (int c = 0; c < 3; ++c) {
        const long r0 = 11008L * c;
        gemm(st, false, X1 + r0 * 1024, 1024, w_gate, DFF, G, DFF, 11008, DFF, 1024);
        gemm(st, false, X1 + r0 * 1024, 1024, w_up, DFF, UP, DFF, 11008, DFF, 1024);
        hipLaunchKernelGGL(swiglu_k, dim3((unsigned)((11008L * DFF + 255) / 256)), dim3(256), 0, st, G, UP, 11008L * DFF);
        gemm(st, false, G, DFF, w_down, 1024, out + O_Y + r0 * 1024, 1024, 11008, 1024, DFF);
    }
    hipLaunchKernelGGL(ln_rows, dim3(R / 4), dim3(256), 0, st, X1, 1024, ALPHA, out + O_Y, 1024, ln3g, ln3b, out + O_Y, 1024, 1024, R, (float*)nullptr, 0);
}
```
